# Optimizing an MI355X kernel written in HIP

```python
import math
import jax, jax.numpy as jnp
from jax import lax
import numpy as np

D_MODEL = 1024
BATCH = 2
SEQ = 8192
DEPTH = 2

CHUNK = 64
N_LEFT_CHUNKS = 8
BAND_CHUNKS = N_LEFT_CHUNKS + 1
N_HEADS = 16
HEAD_DIM = D_MODEL // N_HEADS
MAX_REL = 2 * CHUNK
N_REL = 2 * MAX_REL + 1
CONV_WIDTH = 3
D_FF = ((8 * D_MODEL // 3 + 255) // 256) * 256
N_A = DEPTH // 2
N_B = DEPTH - N_A
EPS = 1e-6

kernel_name = "yoco_shortconv_chunkattn_sandwich_adaln"


def rms_norm(x, g):
    xf = x.astype(jnp.float32)
    y = xf * lax.rsqrt(jnp.mean(xf * xf, axis=-1, keepdims=True) + EPS)
    return (y * g.astype(jnp.float32)).astype(x.dtype)


def modulate(h, shift, scale):
    return h * (1.0 + scale[:, None, :]) + shift[:, None, :]


def short_conv_mixer(h, w_in, conv_k, w_out):
    S = h.shape[1]
    bcx = h @ w_in
    b_gate, c_gate, xin = jnp.split(bcx, 3, axis=-1)
    z = c_gate * xin
    zp = jnp.pad(z, ((0, 0), (CONV_WIDTH - 1, 0), (0, 0)))
    conv = sum(conv_k[k] * zp[:, k:k + S] for k in range(CONV_WIDTH))
    return (b_gate * conv) @ w_out


def gather_band(t):
    Bsz, S = t.shape[0], t.shape[1]
    nc = S // CHUNK
    tc = t.reshape(Bsz, nc, CHUNK, N_HEADS, HEAD_DIM)
    tp = jnp.pad(tc, ((0, 0), (N_LEFT_CHUNKS, 0), (0, 0), (0, 0), (0, 0)))
    idx = jnp.arange(nc)[:, None] + jnp.arange(BAND_CHUNKS)[None, :]
    band = tp[:, idx]
    return band.reshape(Bsz, nc, BAND_CHUNKS * CHUNK, N_HEADS, HEAD_DIM)


def chunk_band_attention(h, k_band, v_band, w_q, w_o, rel_bias):
    Bsz, S, _ = h.shape
    nc = S // CHUNK
    q = (h @ w_q).reshape(Bsz, nc, CHUNK, N_HEADS, HEAD_DIM)
    scores = jnp.einsum('bnqhd,bnkhd->bhnqk', q, k_band).astype(jnp.float32)
    scores = scores * (HEAD_DIM ** -0.5)
    a = jnp.arange(CHUNK)[:, None]
    kk = jnp.arange(BAND_CHUNKS * CHUNK)[None, :]
    j, b = kk // CHUNK, kk % CHUNK
    rel = (N_LEFT_CHUNKS - j) * CHUNK + a - b
    rel_idx = jnp.clip(rel, -MAX_REL, MAX_REL) + MAX_REL
    bias = rel_bias.astype(jnp.float32)[:, rel_idx]
    scores = scores + bias[None, :, None]
    key_chunk = jnp.arange(nc)[:, None] + (jnp.arange(BAND_CHUNKS * CHUNK)[None, :] // CHUNK) - N_LEFT_CHUNKS
    valid = key_chunk >= 0
    scores = jnp.where(valid[None, None, :, None, :], scores, jnp.finfo(jnp.float32).min)
    p = jax.nn.softmax(scores, axis=-1).astype(v_band.dtype)
    o = jnp.einsum('bhnqk,bnkhd->bnqhd', p, v_band)
    return o.reshape(Bsz, S, D_MODEL) @ w_o


def swiglu(h, w_in, w_out):
    gu = h @ w_in
    g, u = jnp.split(gu, 2, axis=-1)
    return (jax.nn.silu(g) * u) @ w_out


def setup_inputs(seed: int = 0) -> dict:
    key = jax.random.key(seed)
    ks = jax.random.split(key, 20)
    nrm = lambda k, shape, fan: jax.random.normal(k, shape, jnp.float32) * (fan ** -0.5)
    D = D_MODEL
    return {
        "x": jax.random.normal(ks[0], (BATCH, SEQ, D), jnp.float32),
        "c": jax.random.normal(ks[1], (BATCH, D), jnp.float32),
        "mod_w": nrm(ks[2], (DEPTH, D, 6 * D), D) * 0.3,
        "mod_b": 0.05 * jax.random.normal(ks[3], (DEPTH, 6 * D), jnp.float32),
        "norm_g": 1.0 + 0.05 * jax.random.normal(ks[4], (DEPTH, 4, D), jnp.float32),
        "ffn_w_in": nrm(ks[5], (DEPTH, D, 2 * D_FF), D),
        "ffn_w_out": nrm(ks[6], (DEPTH, D_FF, D), D_FF),
        "conv_w_in": nrm(ks[7], (N_A, D, 3 * D), D),
        "conv_k": nrm(ks[8], (N_A, CONV_WIDTH, D), CONV_WIDTH),
        "conv_w_out": nrm(ks[9], (N_A, D, D), D),
        "kv_mod_w": nrm(ks[10], (D, 2 * D), D) * 0.3,
        "kv_mod_b": 0.05 * jax.random.normal(ks[11], (2 * D,), jnp.float32),
        "kv_norm_g": 1.0 + 0.05 * jax.random.normal(ks[12], (D,), jnp.float32),
        "w_kv": nrm(ks[13], (D, 2 * D), D),
        "attn_w_q": nrm(ks[14], (N_B, D, D), D),
        "attn_w_o": nrm(ks[15], (N_B, D, D), D),
        "rel_bias": 0.5 * jax.random.normal(ks[16], (N_B, N_HEADS, N_REL), jnp.float32),
    }


def reference(x, c, mod_w, mod_b, norm_g, ffn_w_in, ffn_w_out, conv_w_in, conv_k,
              conv_w_out, kv_mod_w, kv_mod_b, kv_norm_g, w_kv, attn_w_q, attn_w_o,
              rel_bias):
    Bsz, S, _ = x.shape
    silu_c = jax.nn.silu(c)
    k_band = None
    v_band = None
    for layer in range(DEPTH):
        mod = silu_c @ mod_w[layer] + mod_b[layer]
        sh1, sc1, g1, sh2, sc2, g2 = jnp.split(mod, 6, axis=-1)
        h = modulate(rms_norm(x, norm_g[layer, 0]), sh1, sc1)
        if layer < N_A:
            y = short_conv_mixer(h, conv_w_in[layer], conv_k[layer], conv_w_out[layer])
        else:
            if layer == N_A:
                kv_sh, kv_sc = jnp.split(silu_c @ kv_mod_w + kv_mod_b, 2, axis=-1)
                hkv = modulate(rms_norm(x, kv_norm_g), kv_sh, kv_sc)
                k, v = jnp.split(hkv @ w_kv, 2, axis=-1)
                k_band = gather_band(k.reshape(Bsz, S, N_HEADS, HEAD_DIM))
                v_band = gather_band(v.reshape(Bsz, S, N_HEADS, HEAD_DIM))
            bi = layer - N_A
            y = chunk_band_attention(h, k_band, v_band, attn_w_q[bi], attn_w_o[bi], rel_bias[bi])
        x = x + g1[:, None, :] * rms_norm(y, norm_g[layer, 1])
        h = modulate(rms_norm(x, norm_g[layer, 2]), sh2, sc2)
        y = swiglu(h, ffn_w_in[layer], ffn_w_out[layer])
        x = x + g2[:, None, :] * rms_norm(y, norm_g[layer, 3])
    return x
```

```cpp
#include <hip/hip_runtime.h>
#include <cstdio>
#include <cstdint>
namespace pg8 {
#define PG8_LAS __attribute__((address_space(3)))
typedef unsigned short bf16_t;
typedef short bf16x8 __attribute__((ext_vector_type(8)));
typedef float f32x4 __attribute__((ext_vector_type(4)));
typedef unsigned u32x4 __attribute__((ext_vector_type(4)));
constexpr int BM = 256, BK = 64, HALF = 128, HTB = HALF * BK * 2  , STAGE_BYTES = 8 * HTB, NXCD = 8, WGM = 8;

__host__ __device__ __forceinline__ int lds_byte(int r, int c) { const int st = (r >> 4) * 2 + (c >> 5), rr = r & 15, cc = c & 31, ob = rr * 64 + cc * 2; return st * 1024 + (ob ^ (((ob >> 9) & 1) << 5)); }
__host__ __device__ __forceinline__ void stage_rc(int b, int& R, int& C) { const int st = b / 1024, sb = b % 1024, swz = sb ^ (((sb >> 9) & 1) << 5); R = (st >> 1) * 16 + swz / 64; C = (st & 1) * 32 + (swz % 64) / 2; }
__host__ __device__ __forceinline__ int perm32(int rho) { const int n = rho >> 4, i = rho & 15; return 8 * (i >> 2) + 4 * n + (i & 3); }

struct Unit { int pm, pn; };
struct Gemm { const bf16_t* A; const bf16_t* Bt; int M, N, K; };

struct StaticOrder {
    int nM, nN, nwg, G, c;
    __host__ __device__ void init(int M, int N, int G_, int c_) { nM = M / BM; nN = N / BM; nwg = nM * nN; G = G_; c = c_; }
    __host__ __device__ bool next(int i, Unit& u) const {
        const long L = (long)i * G + c; if (L >= nwg) return false;
        int wgid = (int)L; { const int q = nwg / NXCD, r = nwg % NXCD, xcd = wgid % NXCD, off = wgid / NXCD; wgid = (xcd < r ? xcd * (q + 1) : r * (q + 1) + (xcd - r) * q) + off; }
        const int nig = WGM * nN, gid = wgid / nig, fm = gid * WGM, gsz = (nM - fm) < WGM ? (nM - fm) : WGM;
        u.pm = fm + ((wgid % nig) % gsz); u.pn = (wgid % nig) / gsz; return true;
    }
    __device__ __forceinline__ void a_ready(const Unit&) const {}
    __device__ __forceinline__ void done(const Unit&) const {}
};

__device__ __forceinline__ unsigned cvt_pk_bf16(float lo, float hi) { unsigned r; asm volatile("v_cvt_pk_bf16_f32 %0, %1, %2" : "=v"(r) : "v"(lo), "v"(hi)); return r; }
__device__ __forceinline__ u32x4 pack8(const f32x4 v0, const f32x4 v1) { u32x4 w; w.x = cvt_pk_bf16(v0[0], v0[1]); w.y = cvt_pk_bf16(v0[2], v0[3]); w.z = cvt_pk_bf16(v1[0], v1[1]); w.w = cvt_pk_bf16(v1[2], v1[3]); return w; }
struct EpiPlain {
    static constexpr bool PERM = true, AFTER_DRAIN = false;
    bf16_t* O; int ldc;
    __device__ __forceinline__ void operator()(const f32x4 (&acc)[2][2][4][2], const Unit& u, int wr, int wc, int fr, int fq) const {
        const int row0 = u.pm * BM + wr * 64 + fr, col0 = u.pn * BM + wc * 32 + 8 * fq;
#pragma unroll
        for (int ai = 0; ai < 2; ++ai)
#pragma unroll
            for (int m = 0; m < 4; ++m) { bf16_t* rowp = O + (size_t)(row0 + ai * HALF + m * 16) * ldc + col0;
#pragma unroll
                for (int bj = 0; bj < 2; ++bj) *(u32x4*)(rowp + bj * HALF) = pack8(acc[ai][bj][m][0], acc[ai][bj][m][1]); }
    }
};
struct EpiConv {
    static constexpr bool PERM = true, AFTER_DRAIN = false;
    bf16_t* Bg; bf16_t* Z;
    __device__ __forceinline__ void operator()(const f32x4 (&acc)[2][2][4][2], const Unit& u, int wr, int wc, int fr, int fq) const {
        const int row0 = u.pm * BM + wr * 64 + fr;
        if (u.pn < 4) {
            const int col0 = u.pn * BM + wc * 32 + 8 * fq;
#pragma unroll
            for (int ai = 0; ai < 2; ++ai)
#pragma unroll
                for (int m = 0; m < 4; ++m) { bf16_t* rowp = Bg + (size_t)(row0 + ai * HALF + m * 16) * 1024 + col0;
#pragma unroll
                    for (int bj = 0; bj < 2; ++bj) *(u32x4*)(rowp + bj * HALF) = pack8(acc[ai][bj][m][0], acc[ai][bj][m][1]); }
        } else {
            const int col0 = (u.pn - 4) * HALF + wc * 32 + 8 * fq;
#pragma unroll
            for (int ai = 0; ai < 2; ++ai)
#pragma unroll
                for (int m = 0; m < 4; ++m) { bf16_t* rowp = Z + (size_t)(row0 + ai * HALF + m * 16) * 1024 + col0;
                    *(u32x4*)rowp = pack8(acc[ai][0][m][0] * acc[ai][1][m][0], acc[ai][0][m][1] * acc[ai][1][m][1]); }
        }
    }
};
__device__ __forceinline__ f32x4 silu_mul(const f32x4 g, const f32x4 u) { f32x4 r;
#pragma unroll
    for (int i = 0; i < 4; ++i) r[i] = g[i] * __builtin_amdgcn_rcpf(1.0f + __builtin_amdgcn_exp2f(-1.4426950408889634f * g[i])) * u[i];
    return r; }
struct EpiSwiGLU {
    static constexpr bool PERM = true, AFTER_DRAIN = false;
    bf16_t* H; int ldc;
    __device__ __forceinline__ void operator()(const f32x4 (&acc)[2][2][4][2], const Unit& u, int wr, int wc, int fr, int fq) const {
        const int row0 = u.pm * BM + wr * 64 + fr, col0 = u.pn * HALF + wc * 32 + 8 * fq;
#pragma unroll
        for (int ai = 0; ai < 2; ++ai)
#pragma unroll
            for (int m = 0; m < 4; ++m) { bf16_t* rowp = H + (size_t)(row0 + ai * HALF + m * 16) * ldc + col0;
                *(u32x4*)rowp = pack8(silu_mul(acc[ai][0][m][0], acc[ai][1][m][0]), silu_mul(acc[ai][0][m][1], acc[ai][1][m][1])); }
    }
};
struct EpiQK {
    static constexpr bool PERM = true, AFTER_DRAIN = false;
    bf16_t* O; float scale; int perm;
    __device__ __forceinline__ void operator()(const f32x4 (&acc)[2][2][4][2], const Unit& u, int wr, int wc, int fr, int fq) const {
#pragma unroll
        for (int ai = 0; ai < 2; ++ai)
#pragma unroll
            for (int m = 0; m < 4; ++m) { const int token = u.pm * BM + ai * HALF + wr * 64 + m * 16 + fr; const int b = token >> 13, s = token & 8191; int pos = s & 31;
                if (perm) pos = (pos & ~12) | ((pos & 4) << 1) | ((pos & 8) >> 1);
#pragma unroll
                for (int bj = 0; bj < 2; ++bj) { const int c = u.pn * BM + bj * HALF + wc * 32 + 8 * fq; const int h = c >> 6, d = c & 63;
                    const size_t off = ((((size_t)(b * 16 + h) * 256 + (s >> 5)) * 4 + (d >> 4)) * 32 + pos) * 16 + (d & 15);
                    *(u32x4*)(O + off) = pack8(acc[ai][bj][m][0] * scale, acc[ai][bj][m][1] * scale); } }
    }
};
struct EpiVt {
    static constexpr bool PERM = true, AFTER_DRAIN = false;
    bf16_t* O;
    __device__ __forceinline__ void operator()(const f32x4 (&acc)[2][2][4][2], const Unit& u, int wr, int wc, int fr, int fq) const {
#pragma unroll
        for (int ai = 0; ai < 2; ++ai)
#pragma unroll
            for (int m = 0; m < 4; ++m) { const int hd = u.pm * BM + ai * HALF + wr * 64 + m * 16 + fr; const int h = hd >> 6, d = hd & 63;
#pragma unroll
                for (int bj = 0; bj < 2; ++bj) { const int token = u.pn * BM + bj * HALF + wc * 32 + 8 * fq; const int b = token >> 13, s = token & 8191;
                    const size_t off = ((((size_t)(b * 16 + h) * 512 + (s >> 4)) * 64 + d) * 16) + (s & 15);
                    *(u32x4*)(O + off) = pack8(acc[ai][bj][m][0], acc[ai][bj][m][1]); } }
    }
};
template <class Epi, class Sched, bool ALIGN_EPI = false, bool SP2 = false>
__device__ __forceinline__ void gemm_phase(PG8_LAS unsigned char* lds, const Gemm g, const Sched& S, const Epi& E) {
    int tid_ = threadIdx.x; asm volatile("" : "+v"(tid_));
    const int tid = tid_, wid = __builtin_amdgcn_readfirstlane(tid >> 6), lane = tid & 63, wr = wid >> 2, wc = wid & 3, fr = lane & 15, fq = lane >> 4;
    const int K = g.K, nt = K / BK;
    unsigned voffA[2], voffB[2];
#pragma unroll
    for (int i = 0; i < 2; ++i) { int R, C; stage_rc(tid * 16 + i * 8192, R, C); const int Rb = Epi::PERM ? ((R & ~31) + perm32(R & 31)) : R;
        voffA[i] = (unsigned)(R * K + C) * 2u; voffB[i] = (unsigned)(Rb * K + C) * 2u; }
    const size_t kstep = (size_t)(BK * 2);
    const size_t hstep = (size_t)HALF * K * 2;
    const size_t tstep = 2 * hstep;
    const unsigned ldsw = (unsigned)wid * 1024u;
    const int aoff = lds_byte(wr * 64 + fr, fq * 8), boff = lds_byte(wc * 32 + fr, fq * 8);
#define PG8_SA(b, h) (((b) * 2 + (h)) * HTB)
#define PG8_SB(b, h) ((4 + (b) * 2 + (h)) * HTB)
#define PG8_STAGE(bufoff, gbase, voff) do { _Pragma("unroll") for (int _i = 0; _i < 2; ++_i) \
        __builtin_amdgcn_global_load_lds((const unsigned*)((const char*)(gbase) + (voff)[_i]), (PG8_LAS unsigned*)(lds + (bufoff) + ldsw + _i * 8192), 16, 0, 0); } while (0)
#define PG8_LDA(dst, b, h) do { _Pragma("unroll") for (int m = 0; m < 4; ++m) _Pragma("unroll") for (int k = 0; k < 2; ++k) dst[m][k] = *(const PG8_LAS bf16x8*)(lds + PG8_SA(b, h) + aoff + m * 2048 + k * 1024); } while (0)
#define PG8_LDB(dst, b, h) do { _Pragma("unroll") for (int n = 0; n < 2; ++n) _Pragma("unroll") for (int k = 0; k < 2; ++k) dst[n][k] = *(const PG8_LAS bf16x8*)(lds + PG8_SB(b, h) + boff + n * 2048 + k * 1024); } while (0)
#define PG8_MMA(ai, bj, At, Bt) do { __builtin_amdgcn_s_setprio(1); _Pragma("unroll") for (int m = 0; m < 4; ++m) _Pragma("unroll") for (int n = 0; n < 2; ++n) _Pragma("unroll") for (int k = 0; k < 2; ++k) \
        acc[ai][bj][m][n] = __builtin_amdgcn_mfma_f32_16x16x32_bf16(Bt[n][k], At[m][k], acc[ai][bj][m][n], 0, 0, 0); __builtin_amdgcn_s_setprio(0); } while (0)
#define PG8_WAIT_V(n) asm volatile("s_waitcnt vmcnt(" #n ")" ::: "memory")
#define PG8_WAIT_L(n) asm volatile("s_waitcnt lgkmcnt(" #n ")" ::: "memory")
#define PG8_BAR __builtin_amdgcn_s_barrier()
#define PG8_SCHED __builtin_amdgcn_sched_barrier(0)
    Unit cur, nxt; int ui = 0;
    if (!S.next(0, cur)) return;
    f32x4 acc[2][2][4][2];
#pragma unroll
    for (int a = 0; a < 2; ++a)
#pragma unroll
        for (int b = 0; b < 2; ++b)
#pragma unroll
            for (int m = 0; m < 4; ++m)
#pragma unroll
                for (int n = 0; n < 2; ++n) acc[a][b][m][n] = (f32x4){0.f, 0.f, 0.f, 0.f};
    bf16x8 At[4][2], B0[2][2], B1[2][2];
    const char* cA = (const char*)g.A + (size_t)cur.pm * tstep; const char* cB = (const char*)g.Bt + (size_t)cur.pn * tstep;
    S.a_ready(cur);
    if constexpr (SP2) {
        PG8_STAGE(PG8_SB(0, 0), cB, voffB); PG8_STAGE(PG8_SB(0, 1), cB + hstep, voffB); PG8_STAGE(PG8_SA(0, 0), cA, voffA); PG8_STAGE(PG8_SA(0, 1), cA + hstep, voffA);
        if (wr == 1) PG8_BAR;
        PG8_WAIT_V(2); PG8_BAR;
        PG8_STAGE(PG8_SB(1, 0), cB + kstep, voffB); PG8_STAGE(PG8_SA(1, 0), cA + kstep, voffA); PG8_STAGE(PG8_SB(1, 1), cB + hstep + kstep, voffB);
        PG8_WAIT_V(6); PG8_BAR;
    } else {
        PG8_STAGE(PG8_SB(0, 0), cB, voffB); PG8_STAGE(PG8_SA(0, 0), cA, voffA); PG8_STAGE(PG8_SB(0, 1), cB + hstep, voffB); PG8_STAGE(PG8_SA(0, 1), cA + hstep, voffA);
        if (wr == 1) PG8_BAR;
        PG8_WAIT_V(4); PG8_BAR;
        PG8_STAGE(PG8_SB(1, 0), cB + kstep, voffB); PG8_STAGE(PG8_SA(1, 0), cA + kstep, voffA); PG8_STAGE(PG8_SB(1, 1), cB + hstep + kstep, voffB);
        PG8_WAIT_V(6); PG8_BAR;
    }
    for (;;) {
        const bool has_next = S.next(ui + 1, nxt);
        const char* nA = has_next ? (const char*)g.A + (size_t)nxt.pm * tstep : cA; const char* nB = has_next ? (const char*)g.Bt + (size_t)nxt.pn * tstep : cB;
        for (int t = 0; t < nt; t += 2) {
            const bool last = (t == nt - 2);
            const char* a1 = cA + (size_t)(t + 1) * kstep;
            const char* a2 = last ? nA : cA + (size_t)(t + 2) * kstep; const char* b2 = last ? nB : cB + (size_t)(t + 2) * kstep;
            const char* a3 = a2 + kstep; const char* b3 = b2 + kstep;
            if (last && has_next) S.a_ready(nxt);
            if constexpr (SP2) {
            PG8_LDB(B0, 0, 0); PG8_LDB(B1, 0, 1); PG8_SCHED; PG8_LDA(At, 0, 0); PG8_STAGE(PG8_SA(1, 1), a1 + hstep, voffA);
            PG8_WAIT_V(8); PG8_WAIT_L(0); PG8_BAR; PG8_MMA(0, 0, At, B0); PG8_MMA(0, 1, At, B1); PG8_BAR; PG8_SCHED;
            PG8_LDA(At, 0, 1); PG8_STAGE(PG8_SB(0, 0), b2, voffB); PG8_STAGE(PG8_SB(0, 1), b2 + hstep, voffB); PG8_STAGE(PG8_SA(0, 0), a2, voffA);
            PG8_WAIT_V(8); PG8_WAIT_L(0); PG8_BAR; PG8_MMA(1, 0, At, B0); PG8_MMA(1, 1, At, B1); PG8_BAR; PG8_SCHED;
            PG8_LDB(B0, 1, 0); PG8_LDB(B1, 1, 1); PG8_SCHED; PG8_LDA(At, 1, 0); PG8_STAGE(PG8_SA(0, 1), a2 + hstep, voffA);
            PG8_WAIT_V(8); PG8_WAIT_L(0); PG8_BAR; PG8_MMA(0, 0, At, B0); PG8_MMA(0, 1, At, B1); PG8_BAR; PG8_SCHED;
            PG8_LDA(At, 1, 1); PG8_STAGE(PG8_SB(1, 0), b3, voffB); PG8_STAGE(PG8_SB(1, 1), b3 + hstep, voffB); PG8_STAGE(PG8_SA(1, 0), a3, voffA);
            PG8_WAIT_V(8); PG8_WAIT_L(0); PG8_BAR; PG8_MMA(1, 0, At, B0); PG8_MMA(1, 1, At, B1); PG8_BAR; PG8_SCHED;
            } else {
            PG8_LDB(B0, 0, 0); PG8_SCHED; PG8_LDA(At, 0, 0); PG8_STAGE(PG8_SA(1, 1), a1 + hstep, voffA);
            PG8_WAIT_L(8); PG8_BAR; PG8_WAIT_L(0); PG8_MMA(0, 0, At, B0); PG8_BAR; PG8_SCHED;
            PG8_LDB(B1, 0, 1); PG8_STAGE(PG8_SB(0, 0), b2, voffB);
            PG8_BAR; PG8_WAIT_L(0); PG8_MMA(0, 1, At, B1); PG8_BAR;
            PG8_LDA(At, 0, 1); PG8_STAGE(PG8_SA(0, 0), a2, voffA);
            PG8_BAR; PG8_WAIT_L(0); PG8_MMA(1, 0, At, B0); PG8_BAR; PG8_SCHED;
            PG8_STAGE(PG8_SB(0, 1), b2 + hstep, voffB);
            PG8_WAIT_V(6); PG8_BAR; PG8_MMA(1, 1, At, B1); PG8_BAR;
            PG8_LDB(B0, 1, 0); PG8_SCHED; PG8_LDA(At, 1, 0); PG8_STAGE(PG8_SA(0, 1), a2 + hstep, voffA);
            PG8_WAIT_L(8); PG8_BAR; PG8_WAIT_L(0); PG8_MMA(0, 0, At, B0); PG8_BAR; PG8_SCHED;
            PG8_LDB(B1, 1, 1); PG8_STAGE(PG8_SB(1, 0), b3, voffB);
            PG8_BAR; PG8_WAIT_L(0); PG8_MMA(0, 1, At, B1); PG8_BAR;
            PG8_LDA(At, 1, 1); PG8_STAGE(PG8_SA(1, 0), a3, voffA);
            PG8_BAR; PG8_WAIT_L(0); PG8_MMA(1, 0, At, B0); PG8_BAR; PG8_SCHED;
            PG8_STAGE(PG8_SB(1, 1), b3 + hstep, voffB);
            PG8_WAIT_V(6); PG8_BAR; PG8_MMA(1, 1, At, B1); PG8_BAR;
            }
        }
        if constexpr (ALIGN_EPI) { if (wr == 0) PG8_BAR; }
        if constexpr (!Epi::AFTER_DRAIN) { E(acc, cur, wr, wc, fr, fq); S.done(cur); }
        if (!has_next) break;
#pragma unroll
        for (int a = 0; a < 2; ++a)
#pragma unroll
            for (int b = 0; b < 2; ++b)
#pragma unroll
                for (int m = 0; m < 4; ++m)
#pragma unroll
                    for (int n = 0; n < 2; ++n) acc[a][b][m][n] = (f32x4){0.f, 0.f, 0.f, 0.f};
        cur = nxt; cA = nA; cB = nB; ++ui;
        if constexpr (ALIGN_EPI) { if (wr == 1) PG8_BAR; }
    }
    PG8_WAIT_V(0);
    if constexpr (!ALIGN_EPI) { if (wr == 0) PG8_BAR; }
    PG8_BAR;
    if constexpr (Epi::AFTER_DRAIN) { E.fused(acc, cur, wr, wc, fr, fq, lds, wid, lane); S.done(cur); }
#undef PG8_SA
#undef PG8_SB
#undef PG8_STAGE
#undef PG8_LDA
#undef PG8_LDB
#undef PG8_MMA
#undef PG8_WAIT_V
#undef PG8_WAIT_L
#undef PG8_BAR
#undef PG8_SCHED
}
}
#ifndef PG8_SP2
#define PG8_SP2 true
#endif
#ifndef PG8_ALIGN
#define PG8_ALIGN true
#endif
#include <hip/hip_cooperative_groups.h>
namespace cg = cooperative_groups;

constexpr int NWAVES = 8;
constexpr int M = 16384, D = 1024, FF = 2816, SEQ = 8192, NH = 16;
constexpr float EPS = 1e-6f, LOG2E = 1.4426950408889634f, QSCALE = 0.125f * 1.4426950408889634f;
constexpr size_t MiB = 1u << 20;
constexpr size_t WS_MODV = 1 * MiB;
constexpr size_t WS_WCI = 8 * MiB, WS_WCO = 14 * MiB, WS_WFI0 = 16 * MiB, WS_WFO0 = 27 * MiB, WS_WKV = 32 * MiB + 512 * 1024, WS_WQ = WS_WKV + 4 * MiB,
                 WS_WO = WS_WQ + 2 * MiB, WS_WFI1 = WS_WO + 2 * MiB, WS_WFO1 = WS_WFI1 + 11 * MiB;
static_assert(WS_WFO1 + (size_t)FF * D * 2 <= 64 * MiB, "weights");
constexpr size_t WS_S0 = 64 * MiB, WS_S1 = 96 * MiB, WS_S2 = 128 * MiB, WS_S3 = 160 * MiB, WS_S4 = 192 * MiB, WS_END = 224 * MiB;
constexpr int LDS_BYTES = 131072 + 4096;

#define GAS __attribute__((address_space(1)))
#define LAS __attribute__((address_space(3)))
typedef unsigned short bf16;
typedef unsigned v4u __attribute__((ext_vector_type(4)));
typedef unsigned v2u __attribute__((ext_vector_type(2)));
typedef float f32x4 __attribute__((ext_vector_type(4)));
typedef float f32x16 __attribute__((ext_vector_type(16)));
typedef short bf16x8 __attribute__((ext_vector_type(8)));
typedef float f32x2_t __attribute__((ext_vector_type(2))); typedef __bf16 bf16x2_t __attribute__((ext_vector_type(2)));
__device__ __forceinline__ unsigned pk2(float lo, float hi) { f32x2_t v = {lo, hi}; bf16x2_t b = __builtin_convertvector(v, bf16x2_t); return __builtin_bit_cast(unsigned, b); }
__device__ __forceinline__ float bflo(unsigned w) { return __builtin_bit_cast(float, w << 16); }
__device__ __forceinline__ float bfhi(unsigned w) { return __builtin_bit_cast(float, w & 0xffff0000u); }
__device__ __forceinline__ float wave_sum(float v) {
#pragma unroll
    for (int o = 1; o < 64; o <<= 1) v += __shfl_xor(v, o);
    return v;
}
#define LDS_WAIT() asm volatile("s_waitcnt lgkmcnt(0)" ::: "memory")

__device__ __forceinline__ void transpose_item(const float* W, int K, int N, bf16* WT, int mode, LAS float* scr, int item, int lane) {
    const int nblk = N / 32, kb = item / nblk, nb = item % nblk, k0 = 64 * kb, n0 = 32 * nb;
    int dr = n0;
    if (mode == 1) { if (n0 >= 1024) { const int t = (n0 - 1024) >> 10, ch = (n0 - 1024) & 1023; dr = 1024 + 256 * (ch >> 7) + 128 * t + (ch & 127); } }
    else if (mode == 2) { const int t = n0 >= FF ? 1 : 0, ch = n0 - FF * t; dr = 256 * (ch >> 7) + 128 * t + (ch & 127); }
#pragma unroll 8
    for (int i = 0; i < 32; ++i) { const int kk = 2 * i + (lane >> 5); scr[kk * 33 + (lane & 31)] = W[(size_t)(k0 + kk) * N + n0 + (lane & 31)]; }
    LDS_WAIT(); asm volatile("" ::: "memory");
    const int c = lane & 7;
#pragma unroll
    for (int j = 0; j < 4; ++j) { const int n = (lane >> 3) + 8 * j; const LAS float* s = scr + (8 * c) * 33 + n;
        v4u o; o.x = pk2(s[0 * 33], s[1 * 33]); o.y = pk2(s[2 * 33], s[3 * 33]); o.z = pk2(s[4 * 33], s[5 * 33]); o.w = pk2(s[6 * 33], s[7 * 33]);
        *(v4u*)(WT + (size_t)(dr + n) * K + k0 + 8 * c) = o; }
    LDS_WAIT(); asm volatile("" ::: "memory");
}

__device__ __forceinline__ void rownorm_first(const float* x, bf16* XN, const float* ng, const float* sc, const float* sh, int bstride, int gw, int NGW, int lane) {
    for (int b = 0; b < 2; ++b) {
        f32x4 cA[4], cB[4];
#pragma unroll
        for (int j = 0; j < 4; ++j) { const int col = 4 * lane + 256 * j; const f32x4 g = *(const f32x4*)(ng + col), s = *(const f32x4*)(sc + b * bstride + col); cA[j] = g * (1.0f + s); cB[j] = *(const f32x4*)(sh + b * bstride + col); }
        for (int m = b * SEQ + gw; m < (b + 1) * SEQ; m += NGW) {
            f32x4 v[4]; float ss = 0.f;
#pragma unroll
            for (int j = 0; j < 4; ++j) { v[j] = *(const f32x4*)(x + (size_t)m * D + 4 * lane + 256 * j); ss += (v[j].x * v[j].x + v[j].y * v[j].y) + (v[j].z * v[j].z + v[j].w * v[j].w); }
            const float rstd = 1.0f / sqrtf(wave_sum(ss) * (1.0f / D) + EPS);
#pragma unroll
            for (int j = 0; j < 4; ++j) { const f32x4 o = v[j] * rstd * cA[j] + cB[j]; v2u w; w.x = pk2(o.x, o.y); w.y = pk2(o.z, o.w); *(v2u*)(XN + (size_t)m * D + 4 * lane + 256 * j) = w; }
        }
    }
}
struct NormOut { const float* ng; const float* sc; const float* sh; int bstride; bf16* out; };
template <int NOUT>
__device__ __forceinline__ void rowpass(const bf16* Y, const float* xres, float* xout, const float* gate, int gstride, const float* gpost, const NormOut n1, const NormOut n2, int gw, int NGW, int lane) {
    for (int b = 0; b < 2; ++b) {
        f32x4 cG[4], c1A[4], c1B[4], c2A[4], c2B[4];
#pragma unroll
        for (int j = 0; j < 4; ++j) { const int col = 4 * lane + 256 * j;
            cG[j] = *(const f32x4*)(gate + b * gstride + col) * *(const f32x4*)(gpost + col);
            if (NOUT >= 1) { c1A[j] = *(const f32x4*)(n1.ng + col) * (1.0f + *(const f32x4*)(n1.sc + b * n1.bstride + col)); c1B[j] = *(const f32x4*)(n1.sh + b * n1.bstride + col); }
            if (NOUT >= 2) { c2A[j] = *(const f32x4*)(n2.ng + col) * (1.0f + *(const f32x4*)(n2.sc + b * n2.bstride + col)); c2B[j] = *(const f32x4*)(n2.sh + b * n2.bstride + col); } }
        for (int m = b * SEQ + gw; m < (b + 1) * SEQ; m += NGW) {
            f32x4 y[4], xr[4]; float ss = 0.f;
#pragma unroll
            for (int j = 0; j < 4; ++j) { const v2u w = *(const v2u*)(Y + (size_t)m * D + 4 * lane + 256 * j); y[j] = (f32x4){bflo(w.x), bfhi(w.x), bflo(w.y), bfhi(w.y)};
                xr[j] = *(const f32x4*)(xres + (size_t)m * D + 4 * lane + 256 * j); ss += (y[j].x * y[j].x + y[j].y * y[j].y) + (y[j].z * y[j].z + y[j].w * y[j].w); }
            const float rstd = 1.0f / sqrtf(wave_sum(ss) * (1.0f / D) + EPS);
            float s2 = 0.f;
#pragma unroll
            for (int j = 0; j < 4; ++j) { xr[j] = xr[j] + cG[j] * (y[j] * rstd); *(f32x4*)(xout + (size_t)m * D + 4 * lane + 256 * j) = xr[j]; s2 += (xr[j].x * xr[j].x + xr[j].y * xr[j].y) + (xr[j].z * xr[j].z + xr[j].w * xr[j].w); }
            if (NOUT >= 1) {
                const float r2 = 1.0f / sqrtf(wave_sum(s2) * (1.0f / D) + EPS);
#pragma unroll
                for (int j = 0; j < 4; ++j) { const f32x4 t = xr[j] * r2; const f32x4 o = t * c1A[j] + c1B[j]; v2u w; w.x = pk2(o.x, o.y); w.y = pk2(o.z, o.w); *(v2u*)(n1.out + (size_t)m * D + 4 * lane + 256 * j) = w;
                    if (NOUT >= 2) { const f32x4 o2 = t * c2A[j] + c2B[j]; v2u w2; w2.x = pk2(o2.x, o2.y); w2.y = pk2(o2.z, o2.w); *(v2u*)(n2.out + (size_t)m * D + 4 * lane + 256 * j) = w2; } }
            }
        }
    }
}
__device__ __forceinline__ void conv_pass(const bf16* Bg, const bf16* Z, bf16* U, const float* ck, int gw, int NGW, int lane) {
    for (int it = gw; it < (M / 16) * 2; it += NGW) {
        const int t0 = (it >> 1) * 16, ch = (it & 1) * 512 + lane * 8;
        float k0[8], k1[8], k2[8], zm2[8], zm1[8];
#pragma unroll
        for (int i = 0; i < 8; ++i) { k0[i] = ck[ch + i]; k1[i] = ck[D + ch + i]; k2[i] = ck[2 * D + ch + i]; zm2[i] = 0.f; zm1[i] = 0.f; }
        if ((t0 & (SEQ - 1)) != 0) {
            const v4u a = *(const v4u*)(Z + (size_t)(t0 - 2) * D + ch), c = *(const v4u*)(Z + (size_t)(t0 - 1) * D + ch);
            zm2[0] = bflo(a.x); zm2[1] = bfhi(a.x); zm2[2] = bflo(a.y); zm2[3] = bfhi(a.y); zm2[4] = bflo(a.z); zm2[5] = bfhi(a.z); zm2[6] = bflo(a.w); zm2[7] = bfhi(a.w);
            zm1[0] = bflo(c.x); zm1[1] = bfhi(c.x); zm1[2] = bflo(c.y); zm1[3] = bfhi(c.y); zm1[4] = bflo(c.z); zm1[5] = bfhi(c.z); zm1[6] = bflo(c.w); zm1[7] = bfhi(c.w);
        }
#pragma unroll 4
        for (int r = 0; r < 16; ++r) {
            const v4u zz = *(const v4u*)(Z + (size_t)(t0 + r) * D + ch), bb = *(const v4u*)(Bg + (size_t)(t0 + r) * D + ch);
            float z[8], bg[8], o[8];
            z[0] = bflo(zz.x); z[1] = bfhi(zz.x); z[2] = bflo(zz.y); z[3] = bfhi(zz.y); z[4] = bflo(zz.z); z[5] = bfhi(zz.z); z[6] = bflo(zz.w); z[7] = bfhi(zz.w);
            bg[0] = bflo(bb.x); bg[1] = bfhi(bb.x); bg[2] = bflo(bb.y); bg[3] = bfhi(bb.y); bg[4] = bflo(bb.z); bg[5] = bfhi(bb.z); bg[6] = bflo(bb.w); bg[7] = bfhi(bb.w);
#pragma unroll
            for (int i = 0; i < 8; ++i) { o[i] = bg[i] * (k0[i] * zm2[i] + k1[i] * zm1[i] + k2[i] * z[i]); zm2[i] = zm1[i]; zm1[i] = z[i]; }
            v4u w; w.x = pk2(o[0], o[1]); w.y = pk2(o[2], o[3]); w.z = pk2(o[4], o[5]); w.w = pk2(o[6], o[7]);
            *(v4u*)(U + (size_t)(t0 + r) * D + ch) = w;
        }
    }
}

#define MFMA32(a, b, c) __builtin_amdgcn_mfma_f32_32x32x16_bf16((a), (b), (c), 0, 0, 0)
__device__ __forceinline__ void attn_unit(const bf16* Qb, const bf16* Kb, const bf16* Vb, bf16* O, const float* rel_bias, LAS float* bt, int b, int n, int h, int lane) {
    const int r32 = lane & 31, hi = lane >> 5, bh = b * 16 + h;
    for (int i = lane; i < 257; i += 64) bt[i] = rel_bias[h * 257 + i] * LOG2E;
    bf16x8 qf[2][4];
    { const bf16* qp = Qb + ((size_t)(bh * 256 + 2 * n)) * 2048 + r32 * 16 + hi * 8;
#pragma unroll
      for (int qb = 0; qb < 2; ++qb)
#pragma unroll
          for (int d0 = 0; d0 < 4; ++d0) qf[qb][d0] = *(const bf16x8*)(qp + (qb * 4 + d0) * 512); }
    f32x16 o[2][2];
#pragma unroll
    for (int db = 0; db < 2; ++db)
#pragma unroll
        for (int qb = 0; qb < 2; ++qb)
#pragma unroll
            for (int r = 0; r < 16; ++r) o[db][qb][r] = 0.f;
    float mrun[2] = {-1e30f, -1e30f}, lrun[2] = {0.f, 0.f};
    const int kb_first = 2 * (n > 8 ? n - 8 : 0), kb_last = 2 * n + 1;
    const bf16* kbase = Kb + (size_t)bh * 256 * 2048 + r32 * 16 + hi * 8;
    const bf16* vbase = Vb + (size_t)bh * 512 * 1024 + r32 * 16 + hi * 8;
    bf16x8 kf[4], vf[2][2], kn[4], vn[2][2];
#define LOADKV(KF, VF, kb) do { _Pragma("unroll") for (int d0 = 0; d0 < 4; ++d0) KF[d0] = *(const bf16x8*)(kbase + ((size_t)(kb) * 4 + d0) * 512); \
        _Pragma("unroll") for (int db = 0; db < 2; ++db) _Pragma("unroll") for (int ii = 0; ii < 2; ++ii) VF[db][ii] = *(const bf16x8*)(vbase + ((size_t)(2 * (kb) + ii) * 64 + 32 * db) * 16); } while (0)
    LOADKV(kf, vf, kb_first);
    LDS_WAIT();
    for (int kb = kb_first; kb <= kb_last; ++kb) {
        if (kb < kb_last) { LOADKV(kn, vn, kb + 1); }
        const int j = (kb >> 1) - n + 8, half = kb & 1;
        f32x16 s[2];
#pragma unroll
        for (int qb = 0; qb < 2; ++qb) {
#pragma unroll
            for (int r = 0; r < 16; ++r) s[qb][r] = 0.f;
#pragma unroll
            for (int d0 = 0; d0 < 4; ++d0) s[qb] = MFMA32(kf[d0], qf[qb][d0], s[qb]);
        }
        if (j <= 5) {
            const float cb = bt[256];
#pragma unroll
            for (int qb = 0; qb < 2; ++qb)
#pragma unroll
                for (int r = 0; r < 16; ++r) s[qb][r] += cb;
        } else {
            const int base = (8 - j) * 64 + r32 - 32 * half - 8 * hi;
#pragma unroll
            for (int qb = 0; qb < 2; ++qb)
#pragma unroll
                for (int r = 0; r < 16; ++r) { int rel = base + 32 * qb - (16 * (r >> 3) + (r & 7)); rel = rel > 128 ? 128 : rel; s[qb][r] += bt[rel + 128]; }
        }
        bf16x8 pf[2][2];
#pragma unroll
        for (int qb = 0; qb < 2; ++qb) {
            float mx = s[qb][0];
#pragma unroll
            for (int r = 1; r < 16; ++r) mx = fmaxf(mx, s[qb][r]);
            mx = fmaxf(mx, __shfl_xor(mx, 32));
            const float mnew = fmaxf(mrun[qb], mx), alpha = __builtin_amdgcn_exp2f(mrun[qb] - mnew);
            mrun[qb] = mnew;
            float sum = 0.f;
#pragma unroll
            for (int r = 0; r < 16; ++r) { const float p = __builtin_amdgcn_exp2f(s[qb][r] - mnew); s[qb][r] = p; sum += p; }
            lrun[qb] = lrun[qb] * alpha + sum;
#pragma unroll
            for (int db = 0; db < 2; ++db)
#pragma unroll
                for (int r = 0; r < 16; ++r) o[db][qb][r] *= alpha;
#pragma unroll
            for (int ii = 0; ii < 2; ++ii) { v4u w; w.x = pk2(s[qb][8 * ii + 0], s[qb][8 * ii + 1]); w.y = pk2(s[qb][8 * ii + 2], s[qb][8 * ii + 3]); w.z = pk2(s[qb][8 * ii + 4], s[qb][8 * ii + 5]); w.w = pk2(s[qb][8 * ii + 6], s[qb][8 * ii + 7]);
                pf[qb][ii] = __builtin_bit_cast(bf16x8, w); }
        }
#pragma unroll
        for (int db = 0; db < 2; ++db)
#pragma unroll
            for (int qb = 0; qb < 2; ++qb)
#pragma unroll
                for (int ii = 0; ii < 2; ++ii) o[db][qb] = MFMA32(vf[db][ii], pf[qb][ii], o[db][qb]);
        if (kb < kb_last) {
#pragma unroll
            for (int d0 = 0; d0 < 4; ++d0) kf[d0] = kn[d0];
#pragma unroll
            for (int db = 0; db < 2; ++db)
#pragma unroll
                for (int ii = 0; ii < 2; ++ii) vf[db][ii] = vn[db][ii];
        }
    }
#undef LOADKV
#pragma unroll
    for (int qb = 0; qb < 2; ++qb) {
        const float l = lrun[qb] + __shfl_xor(lrun[qb], 32), inv = 1.0f / l;
        bf16* op = O + (size_t)(b * SEQ + 64 * n + 32 * qb + r32) * D + h * 64 + 4 * hi;
#pragma unroll
        for (int db = 0; db < 2; ++db)
#pragma unroll
            for (int rq = 0; rq < 4; ++rq) { v2u w; w.x = pk2(o[db][qb][4 * rq + 0] * inv, o[db][qb][4 * rq + 1] * inv); w.y = pk2(o[db][qb][4 * rq + 2] * inv, o[db][qb][4 * rq + 3] * inv);
                *(v2u*)(op + 32 * db + 8 * rq) = w; }
    }
    LDS_WAIT();
}

struct Args { const float* in[17]; float* out; unsigned char* ws; };
__global__ void __launch_bounds__(NWAVES * 64, 2) fwd_kernel(Args args) {
    extern __shared__ __attribute__((aligned(16))) unsigned char lds[];
    cg::grid_group grid = cg::this_grid();
    LAS unsigned char* L = (LAS unsigned char*)lds;
    const int wave = __builtin_amdgcn_readfirstlane((int)threadIdx.x >> 6);
#define PH_TID() int tid = threadIdx.x; asm volatile("" : "+v"(tid)); const int lane = tid & 63; (void)lane
    const int G = gridDim.x, bx = blockIdx.x;
    const int vcu = (G % 8 == 0) ? (bx % 8) * (G / 8) + bx / 8 : bx;
    const int gw = vcu * NWAVES + wave, NGW = G * NWAVES;
    unsigned char* ws = args.ws;
    const float* x = args.in[0]; const float* cvec = args.in[1]; const float* mod_w = args.in[2]; const float* mod_b = args.in[3]; const float* norm_g = args.in[4];
    const float* ffn_w_in = args.in[5]; const float* ffn_w_out = args.in[6]; const float* conv_w_in = args.in[7]; const float* conv_k = args.in[8]; const float* conv_w_out = args.in[9];
    const float* kv_mod_w = args.in[10]; const float* kv_mod_b = args.in[11]; const float* kv_norm_g = args.in[12]; const float* w_kv = args.in[13]; const float* w_q = args.in[14];
    const float* w_o = args.in[15]; const float* rel_bias = args.in[16];
    float* out = args.out;
    float* modv = (float*)(ws + WS_MODV);
    float* kvmod = modv + 4 * 6144;
    bf16* Wci = (bf16*)(ws + WS_WCI); bf16* Wco = (bf16*)(ws + WS_WCO); bf16* Wfi0 = (bf16*)(ws + WS_WFI0); bf16* Wfo0 = (bf16*)(ws + WS_WFO0); bf16* Wkv = (bf16*)(ws + WS_WKV);
    bf16* Wq = (bf16*)(ws + WS_WQ); bf16* Wo = (bf16*)(ws + WS_WO); bf16* Wfi1 = (bf16*)(ws + WS_WFI1); bf16* Wfo1 = (bf16*)(ws + WS_WFO1);
    bf16* S0 = (bf16*)(ws + WS_S0); bf16* S1 = (bf16*)(ws + WS_S1); bf16* S2 = (bf16*)(ws + WS_S2); bf16* S3 = (bf16*)(ws + WS_S3); bf16* S4 = (bf16*)(ws + WS_S4);

    {
        PH_TID();
        LAS float* sc = (LAS float*)L; LAS float* red = sc + 2048;
        for (int i = tid; i < 2048; i += NWAVES * 64) { const float v = cvec[i]; sc[i] = v / (1.0f + __expf(-v)); }
        __syncthreads();
        for (int it = bx; it < 224; it += G) {
            const float* W; const float* bias; float* o; int ldw, col0;
            if (it < 96) { W = mod_w; bias = mod_b; o = modv; ldw = 6144; col0 = it * 64; }
            else if (it < 192) { W = mod_w + (size_t)D * 6144; bias = mod_b + 6144; o = modv + 2 * 6144; ldw = 6144; col0 = (it - 96) * 64; }
            else { W = kv_mod_w; bias = kv_mod_b; o = kvmod; ldw = 2048; col0 = (it - 192) * 64; }
            const float* wp = W + (size_t)(wave * 128) * ldw + col0 + lane;
            float a0 = 0.f, a1 = 0.f;
#pragma unroll 16
            for (int k = 0; k < 128; ++k) { const float wv = wp[(size_t)k * ldw]; a0 += sc[wave * 128 + k] * wv; a1 += sc[1024 + wave * 128 + k] * wv; }
            red[(wave * 2 + 0) * 64 + lane] = a0; red[(wave * 2 + 1) * 64 + lane] = a1;
            __syncthreads();
            if (tid < 128) { const int b = tid >> 6, l = tid & 63; float s = bias[col0 + l];
#pragma unroll
                for (int w = 0; w < 8; ++w) s += red[(w * 2 + b) * 64 + l];
                o[b * ldw + col0 + l] = s; }
            __syncthreads();
        }
        __syncthreads();
        LAS float* scr = (LAS float*)(L + wave * 16384);
        constexpr int I_CI = 16 * 96, I_CO = 16 * 32, I_FI = 16 * 176, I_FO = 44 * 32, I_KV = 16 * 64, I_Q = 16 * 32;
        constexpr int NITEMS = I_CI + I_CO + 2 * I_FI + 2 * I_FO + I_KV + 2 * I_Q;
        for (int it = gw; it < NITEMS; it += NGW) {
            int r = it;
            if (r < I_CI) { transpose_item(conv_w_in, D, 3 * D, Wci, 1, scr, r, lane); continue; } r -= I_CI;
            if (r < I_CO) { transpose_item(conv_w_out, D, D, Wco, 0, scr, r, lane); continue; } r -= I_CO;
            if (r < I_FI) { transpose_item(ffn_w_in, D, 2 * FF, Wfi0, 2, scr, r, lane); continue; } r -= I_FI;
            if (r < I_FO) { transpose_item(ffn_w_out, FF, D, Wfo0, 0, scr, r, lane); continue; } r -= I_FO;
            if (r < I_KV) { transpose_item(w_kv, D, 2 * D, Wkv, 0, scr, r, lane); continue; } r -= I_KV;
            if (r < I_Q) { transpose_item(w_q, D, D, Wq, 0, scr, r, lane); continue; } r -= I_Q;
            if (r < I_Q) { transpose_item(w_o, D, D, Wo, 0, scr, r, lane); continue; } r -= I_Q;
            if (r < I_FI) { transpose_item(ffn_w_in + (size_t)D * 2 * FF, D, 2 * FF, Wfi1, 2, scr, r, lane); continue; } r -= I_FI;
            transpose_item(ffn_w_out + (size_t)FF * D, FF, D, Wfo1, 0, scr, r, lane);
        }
    }
    grid.sync();
    const float* mod0 = modv; const float* mod1 = modv + 2 * 6144;
    { PH_TID(); rownorm_first(x, S0, norm_g + 0 * D, mod0 + 1024, mod0 + 0, 6144, gw, NGW, lane); }
    grid.sync();
    { pg8::Gemm g{S0, Wci, M, 3 * D, D}; pg8::StaticOrder S; S.init(M, 3 * D, G, bx); pg8::EpiConv E{S1, S2};
      pg8::gemm_phase<pg8::EpiConv, pg8::StaticOrder, PG8_ALIGN, PG8_SP2>(L, g, S, E); }
    grid.sync();
    { PH_TID(); conv_pass(S1, S2, S3, conv_k, gw, NGW, lane); }
    grid.sync();
    { pg8::Gemm g{S3, Wco, M, D, D}; pg8::StaticOrder S; S.init(M, D, G, bx); pg8::EpiPlain E{S1, D};
      pg8::gemm_phase<pg8::EpiPlain, pg8::StaticOrder, PG8_ALIGN, PG8_SP2>(L, g, S, E); }
    grid.sync();
    { PH_TID(); const NormOut n1{norm_g + 2 * D, mod0 + 4096, mod0 + 3072, 6144, S0};
      rowpass<1>(S1, x, out, mod0 + 2048, 6144, norm_g + 1 * D, n1, n1, gw, NGW, lane); }
    grid.sync();
    { pg8::Gemm g{S0, Wfi0, M, 2 * FF, D}; pg8::StaticOrder S; S.init(M, 2 * FF, G, bx); pg8::EpiSwiGLU E{S1, FF};
      pg8::gemm_phase<pg8::EpiSwiGLU, pg8::StaticOrder, PG8_ALIGN, PG8_SP2>(L, g, S, E); }
    grid.sync();
    { pg8::Gemm g{S1, Wfo0, M, D, FF}; pg8::StaticOrder S; S.init(M, D, G, bx); pg8::EpiPlain E{S4, D};
      pg8::gemm_phase<pg8::EpiPlain, pg8::StaticOrder, PG8_ALIGN, PG8_SP2>(L, g, S, E); }
    grid.sync();
    { PH_TID(); const NormOut n1{kv_norm_g, kvmod + 1024, kvmod + 0, 2048, S0}; const NormOut n2{norm_g + 4 * D, mod1 + 1024, mod1 + 0, 6144, S1};
      rowpass<2>(S4, out, out, mod0 + 5120, 6144, norm_g + 3 * D, n1, n2, gw, NGW, lane); }
    grid.sync();
    { pg8::Gemm g{S1, Wq, M, D, D}; pg8::StaticOrder S; S.init(M, D, G, bx); pg8::EpiQK E{S2, QSCALE, 0};
      pg8::gemm_phase<pg8::EpiQK, pg8::StaticOrder, PG8_ALIGN, PG8_SP2>(L, g, S, E); }
    { pg8::Gemm g{S0, Wkv, M, D, D}; pg8::StaticOrder S; S.init(M, D, G, bx); pg8::EpiQK E{S3, 1.0f, 1};
      pg8::gemm_phase<pg8::EpiQK, pg8::StaticOrder, PG8_ALIGN, PG8_SP2>(L, g, S, E); }
    { pg8::Gemm g{Wkv + (size_t)D * D, S0, D, M, D}; pg8::StaticOrder S; S.init(D, M, G, bx); pg8::EpiVt E{S4};
      pg8::gemm_phase<pg8::EpiVt, pg8::StaticOrder, PG8_ALIGN, PG8_SP2>(L, g, S, E); }
    grid.sync();
    { PH_TID(); LAS float* bt = (LAS float*)(L + wave * 2048);
      for (int ci = vcu; ci < 2 * (SEQ / 64); ci += G) { const int b = ci >> 7, n = ci & 127;
          for (int hh = 0; hh < 2; ++hh) attn_unit(S2, S3, S4, S0, rel_bias, bt, b, n, wave + 8 * hh, lane); } }
    grid.sync();
    { pg8::Gemm g{S0, Wo, M, D, D}; pg8::StaticOrder S; S.init(M, D, G, bx); pg8::EpiPlain E{S1, D};
      pg8::gemm_phase<pg8::EpiPlain, pg8::StaticOrder, PG8_ALIGN, PG8_SP2>(L, g, S, E); }
    grid.sync();
    { PH_TID(); const NormOut n1{norm_g + 6 * D, mod1 + 4096, mod1 + 3072, 6144, S0};
      rowpass<1>(S1, out, out, mod1 + 2048, 6144, norm_g + 5 * D, n1, n1, gw, NGW, lane); }
    grid.sync();
    { pg8::Gemm g{S0, Wfi1, M, 2 * FF, D}; pg8::StaticOrder S; S.init(M, 2 * FF, G, bx); pg8::EpiSwiGLU E{S1, FF};
      pg8::gemm_phase<pg8::EpiSwiGLU, pg8::StaticOrder, PG8_ALIGN, PG8_SP2>(L, g, S, E); }
    grid.sync();
    { pg8::Gemm g{S1, Wfo1, M, D, FF}; pg8::StaticOrder S; S.init(M, D, G, bx); pg8::EpiPlain E{S4, D};
      pg8::gemm_phase<pg8::EpiPlain, pg8::StaticOrder, PG8_ALIGN, PG8_SP2>(L, g, S, E); }
    grid.sync();
    { PH_TID(); const NormOut n1{norm_g, mod1, mod1, 6144, S0};
      rowpass<0>(S4, out, out, mod1 + 5120, 6144, norm_g + 7 * D, n1, n1, gw, NGW, lane); }
}

extern "C" void kernel_launch(void* const* d_in, const int* in_sizes, int n_in, void* d_out, int out_size, void* d_ws, size_t ws_size, hipStream_t stream) {
    static int grid = 0;
    if (grid == 0) {
        if (n_in != 17 || out_size != M * D || ws_size < WS_END) { fprintf(stderr, "kernel_launch: unexpected shapes (n_in %d out %d ws %zu)\n", n_in, out_size, ws_size); grid = -1; return; }
        int dev = 0, cus = 0, per_cu = 0;
        if (hipGetDevice(&dev) != hipSuccess || hipDeviceGetAttribute(&cus, hipDeviceAttributeMultiprocessorCount, dev) != hipSuccess) { grid = -1; return; }
        if (hipFuncSetAttribute((const void*)fwd_kernel, hipFuncAttributeMaxDynamicSharedMemorySize, LDS_BYTES) != hipSuccess) { fprintf(stderr, "kernel_launch: hipFuncSetAttribute failed\n"); grid = -1; return; }
        if (hipOccupancyMaxActiveBlocksPerMultiprocessor(&per_cu, (const void*)fwd_kernel, NWAVES * 64, LDS_BYTES) != hipSuccess || per_cu < 1) per_cu = 1;
        (void)hipGetLastError();
        grid = cus * per_cu;
    }
    if (grid < 0) return;
    Args a{};
    for (int i = 0; i < 17; ++i) a.in[i] = (const float*)d_in[i];
    a.out = (float*)d_out; a.ws = (unsigned char*)d_ws;
    void* kargs[] = {&a};
    hipError_t e = hipLaunchCooperativeKernel((const void*)fwd_kernel, dim3(grid), dim3(NWAVES * 64), kargs, LDS_BYTES, stream);
    if (e != hipSuccess) fprintf(stderr, "kernel_launch: cooperative launch failed: %s (grid %d)\n", hipGetErrorString(e), grid);
}
```
